# Optimizing an MI355X kernel written in HIP

```python
import math
import jax
import jax.numpy as jnp
from jax import lax
import numpy as np


D_MODEL = 2048
BATCH = 2
SEQ = 4096
DEPTH = 1

A_HEADS = 8
A_DQK = 64
A_DV = 2 * A_DQK
B_HEADS = 16
B_GROUPS = 4
B_HPG = B_HEADS // B_GROUPS
B_DH = 64
CMP_LEN = 32
CMP_STRIDE = 16
CMP_HIDDEN = 256
SEL_BLOCK = 64
SEL_TOPN = 16
WINDOW = 512
N_NSA_BRANCH = 3
MEM_TOKENS = 256
M_HEADS = 4
M_DH = 256
REL_BUCKETS = 32
REL_MAX_DIST = 1024
PEER_HEADS = 8
PEER_NKEYS = 128
PEER_DKEY = 256
PEER_TOPK = 16
PEER_EXPERTS = PEER_NKEYS * PEER_NKEYS
N_BRANCH = 3
MIX_W = 1024
IN_WIDTHS = (A_HEADS * 2 * A_DQK, A_HEADS * 2 * A_DQK, A_HEADS * A_DV, B_HEADS * B_DH, N_NSA_BRANCH * 2 * B_GROUPS * B_DH, N_NSA_BRANCH * B_HEADS, M_HEADS * M_DH, N_BRANCH * D_MODEL)
C_IN = sum(IN_WIDTHS)
Q_BLOCK = 128
PEER_CHUNK = 128
LN_EPS = 1e-5
FORCE = 1e9
ALPHA = (2 * DEPTH) ** 0.25
BETA = (8 * DEPTH) ** -0.25

kernel_name = 'hybrid_diffattn_nsa_mem_peer_deepnorm'


def lambda_init(layer_idx):
    return 0.8 - 0.6 * math.exp(-0.3 * layer_idx)


def layer_norm(x, g, b):
    xf = x.astype(jnp.float32)
    mu = jnp.mean(xf, axis=-1, keepdims=True)
    var = jnp.mean(jnp.square(xf - mu), axis=-1, keepdims=True)
    return ((xf - mu) * lax.rsqrt(var + LN_EPS) * g + b).astype(x.dtype)


def rms_norm(x, g):
    xf = x.astype(jnp.float32)
    return (xf * lax.rsqrt(jnp.mean(jnp.square(xf), axis=-1, keepdims=True) + LN_EPS) * g).astype(x.dtype)


def masked_softmax(s, mask):
    s = jnp.where(mask, s.astype(jnp.float32), -jnp.inf)
    m = jnp.max(s, axis=-1, keepdims=True)
    m = jnp.where(jnp.isfinite(m), m, 0.0)
    e = jnp.where(mask, jnp.exp(s - m), 0.0)
    return e / jnp.maximum(jnp.sum(e, axis=-1, keepdims=True), 1e-30)


def rel_bucket(dist):
    n = jnp.maximum(dist, 0)
    max_exact = REL_BUCKETS // 2
    nf = jnp.maximum(n, 1).astype(jnp.float32)
    large = max_exact + (jnp.log(nf / max_exact) / math.log(REL_MAX_DIST / max_exact) * (REL_BUCKETS - max_exact)).astype(jnp.int32)
    large = jnp.minimum(large, REL_BUCKETS - 1)
    return jnp.where(n < max_exact, n, large)


def group_bias(tab_g, bkt):
    return jnp.moveaxis(tab_g[:, bkt], 0, 1)


def gather_blocks(blocks, idx):
    g = jax.vmap(jax.vmap(lambda kb, i: kb[i]))(blocks, idx)
    return g.reshape(idx.shape[0], idx.shape[1], idx.shape[2], -1, blocks.shape[-1])


def diff_attention(q, k, v, lam_params, subln_g, rel_tab, lam_init):
    B, T = q.shape[:2]
    nb = T // Q_BLOCK
    qh = q.transpose(0, 2, 3, 1, 4)
    kh = k.transpose(0, 2, 3, 1, 4)
    vh = v.transpose(0, 2, 1, 3)
    q_blocks = jnp.moveaxis(qh.reshape(B, A_HEADS, 2, nb, Q_BLOCK, A_DQK), 3, 0)
    lp = lam_params.astype(jnp.float32)
    lam = jnp.exp(jnp.sum(lp[0] * lp[1])) - jnp.exp(jnp.sum(lp[2] * lp[3])) + lam_init
    kpos = jnp.arange(T)
    scale = A_DQK ** -0.5

    def block(args):
        q_blk, i = args
        qpos = i * Q_BLOCK + jnp.arange(Q_BLOCK)
        dist = qpos[:, None] - kpos[None, :]
        bias = jnp.moveaxis(rel_tab[rel_bucket(dist)], -1, 0)
        s = jnp.einsum('bhmqd,bhmkd->bhmqk', q_blk, kh).astype(jnp.float32) * scale + bias[:, None]
        p = masked_softmax(s, dist >= 0)
        w = p[:, :, 0] - lam * p[:, :, 1]
        return jnp.einsum('bhqk,bhkd->bhqd', w.astype(vh.dtype), vh)

    o = lax.map(block, (q_blocks, jnp.arange(nb)))
    o = jnp.moveaxis(o, 0, 2).reshape(B, A_HEADS, T, A_DV).transpose(0, 2, 1, 3)
    o = rms_norm(o, subln_g) * (1.0 - lam_init)
    return o.reshape(B, T, A_HEADS * A_DV)


def nsa_attention(q, kv, gate_logits, cmp_pe, cmp_w1, cmp_w2, rel_tab):
    B, T = q.shape[:2]
    nb = T // Q_BLOCK
    n_sel = T // SEL_BLOCK
    n_top = min(SEL_TOPN, n_sel)
    n_c = (T - CMP_LEN) // CMP_STRIDE + 1
    scale = B_DH ** -0.5
    tpos = jnp.arange(T)
    qh = q.reshape(B, T, B_GROUPS, B_HPG, B_DH).transpose(0, 2, 3, 1, 4)
    kv = kv.transpose(2, 3, 0, 4, 1, 5)

    cidx = jnp.arange(n_c)[:, None] * CMP_STRIDE + jnp.arange(CMP_LEN)[None, :]

    def compress(raw, pe, w1, w2):
        blk = raw[:, :, cidx] + pe
        return jax.nn.gelu(blk.reshape(B, B_GROUPS, n_c, CMP_LEN * B_DH) @ w1) @ w2

    k_cmp = compress(kv[0, 0], cmp_pe[0], cmp_w1[0], cmp_w2[0])
    v_cmp = compress(kv[0, 1], cmp_pe[1], cmp_w1[1], cmp_w2[1])
    c_end = jnp.arange(n_c) * CMP_STRIDE + CMP_LEN - 1
    s_c = jnp.einsum('bghtd,bgcd->bghtc', qh, k_cmp).astype(jnp.float32) * scale
    p_c = masked_softmax(s_c, c_end[None, :] <= tpos[:, None])
    o_cmp = jnp.einsum('bghtc,bgcd->bghtd', p_c.astype(v_cmp.dtype), v_cmp)

    overlap = jax.nn.one_hot(cidx // SEL_BLOCK, n_sel, dtype=jnp.float32).mean(axis=1)
    imp = jnp.einsum('bghtc,cj->bgtj', p_c, overlap)
    blk_ids = jnp.arange(n_sel)[None, :]
    cur = (tpos // SEL_BLOCK)[:, None]
    forced = (blk_ids == 0) | (blk_ids == cur) | (blk_ids == cur - 1)
    future = blk_ids * SEL_BLOCK > tpos[:, None]
    imp = jnp.where(forced, FORCE, jnp.where(future, -FORCE, imp))
    _, sel_idx = lax.top_k(imp, n_top)

    ks_blocks = kv[1, 0].reshape(B, B_GROUPS, n_sel, SEL_BLOCK, B_DH)
    vs_blocks = kv[1, 1].reshape(B, B_GROUPS, n_sel, SEL_BLOCK, B_DH)
    pad = ((0, 0), (0, 0), (WINDOW, 0), (0, 0))
    k_wp = jnp.pad(kv[2, 0], pad)
    v_wp = jnp.pad(kv[2, 1], pad)
    tab_g = rel_tab.T.reshape(B_GROUPS, B_HPG, REL_BUCKETS)

    q_blocks = jnp.moveaxis(qh.reshape(B, B_GROUPS, B_HPG, nb, Q_BLOCK, B_DH), 3, 0)
    sel_blocks = jnp.moveaxis(sel_idx.reshape(B, B_GROUPS, nb, Q_BLOCK, n_top), 2, 0)

    def block(args):
        q_blk, sel_b, i = args
        q0 = i * Q_BLOCK
        qpos = q0 + jnp.arange(Q_BLOCK)
        kg = gather_blocks(ks_blocks, sel_b)
        vg = gather_blocks(vs_blocks, sel_b)
        kpos = (sel_b[..., None] * SEL_BLOCK + jnp.arange(SEL_BLOCK)).reshape(B, B_GROUPS, Q_BLOCK, -1)
        dist = qpos[:, None] - kpos
        bias = jax.vmap(group_bias, in_axes=(0, 1), out_axes=1)(tab_g, rel_bucket(dist))
        s = jnp.einsum('bghqd,bgqkd->bghqk', q_blk, kg).astype(jnp.float32) * scale + bias
        p = masked_softmax(s, (dist >= 0)[:, :, None])
        o_sel = jnp.einsum('bghqk,bgqkd->bghqd', p.astype(vg.dtype), vg)
        kw = lax.dynamic_slice_in_dim(k_wp, q0, WINDOW + Q_BLOCK, axis=2)
        vw = lax.dynamic_slice_in_dim(v_wp, q0, WINDOW + Q_BLOCK, axis=2)
        kpos_w = q0 - WINDOW + jnp.arange(WINDOW + Q_BLOCK)
        dist_w = qpos[:, None] - kpos_w[None, :]
        mask_w = (dist_w >= 0) & (dist_w < WINDOW) & (kpos_w >= 0)[None, :]
        bias_w = jnp.moveaxis(rel_tab[rel_bucket(dist_w)], -1, 0).reshape(B_GROUPS, B_HPG, Q_BLOCK, -1)
        s_w = jnp.einsum('bghqd,bgkd->bghqk', q_blk, kw).astype(jnp.float32) * scale + bias_w
        p_w = masked_softmax(s_w, mask_w)
        o_win = jnp.einsum('bghqk,bgkd->bghqd', p_w.astype(vw.dtype), vw)
        return o_sel, o_win

    o_sel, o_win = lax.map(block, (q_blocks, sel_blocks, jnp.arange(nb)))

    def unblock(o):
        return jnp.moveaxis(o, 0, 3).reshape(B, B_GROUPS, B_HPG, T, B_DH)

    g = jax.nn.sigmoid(gate_logits.astype(jnp.float32)).astype(q.dtype)
    g = g.reshape(B, T, N_NSA_BRANCH, B_GROUPS, B_HPG).transpose(2, 0, 3, 4, 1)[..., None]
    o = g[0] * o_cmp + g[1] * unblock(o_sel) + g[2] * unblock(o_win)
    return o.transpose(0, 3, 1, 2, 4).reshape(B, T, B_HEADS * B_DH)


def memory_attention(q, mem, w_kv):
    B, T = q.shape[:2]
    qh = q.reshape(B, T, M_HEADS, M_DH)
    kv = (mem @ w_kv).reshape(B, mem.shape[1], 2, M_HEADS, M_DH)
    s = jnp.einsum('bthd,bmhd->bhtm', qh, kv[:, :, 0]).astype(jnp.float32) * (M_DH ** -0.5)
    p = jax.nn.softmax(s, axis=-1)
    o = jnp.einsum('bhtm,bmhd->bthd', p.astype(kv.dtype), kv[:, :, 1])
    return o.reshape(B, T, M_HEADS * M_DH)


def peer_ffn(x, w_q, sub_keys, u_tab, v_tab):
    B, T, D = x.shape
    n_tok = B * T
    xf = x.reshape(n_tok, D)
    q = (xf @ w_q).reshape(n_tok, PEER_HEADS, 2, PEER_DKEY // 2)
    s = jnp.einsum('nhcd,hckd->nhck', q, sub_keys).astype(jnp.float32)
    s_top, i_top = lax.top_k(s, PEER_TOPK)
    comb = (s_top[:, :, 0, :, None] + s_top[:, :, 1, None, :]).reshape(n_tok, PEER_HEADS, -1)
    cand = (i_top[:, :, 0, :, None] * PEER_NKEYS + i_top[:, :, 1, None, :]).reshape(n_tok, PEER_HEADS, -1)
    s_fin, pos = lax.top_k(comb, PEER_TOPK)
    experts = jnp.take_along_axis(cand, pos, axis=-1)
    gate = jax.nn.softmax(s_fin, axis=-1)
    nc = n_tok // PEER_CHUNK

    def chunk(args):
        xc, ec, gc = args
        hid = jax.nn.gelu(jnp.einsum('cd,chkd->chk', xc, u_tab[ec]).astype(jnp.float32))
        return jnp.einsum('chk,chkd->cd', (gc * hid).astype(v_tab.dtype), v_tab[ec])

    out = lax.map(chunk, (xf.reshape(nc, PEER_CHUNK, D), experts.reshape(nc, PEER_CHUNK, PEER_HEADS, PEER_TOPK), gate.reshape(nc, PEER_CHUNK, PEER_HEADS, PEER_TOPK)))
    return out.reshape(B, T, D)


def setup_inputs(seed: int = 0) -> dict:
    key = jax.random.key(seed)
    ks = jax.random.split(key, 20)
    f32 = jnp.float32
    nrm = lambda k, shape, sc: jax.random.normal(k, shape, f32) * sc
    return {
        'x': nrm(ks[0], (BATCH, SEQ, D_MODEL), 1.0),
        'mem': nrm(ks[1], (BATCH, MEM_TOKENS, D_MODEL), 1.0),
        'w_in': nrm(ks[2], (DEPTH, D_MODEL, C_IN), D_MODEL ** -0.5),
        'diff_lambda': nrm(ks[3], (DEPTH, 4, A_DQK), 0.1),
        'diff_subln': 1.0 + nrm(ks[4], (DEPTH, A_DV), 0.02),
        'cmp_pe': nrm(ks[5], (DEPTH, 2, CMP_LEN, B_DH), 0.1),
        'cmp_w1': nrm(ks[6], (DEPTH, 2, CMP_LEN * B_DH, CMP_HIDDEN), (CMP_LEN * B_DH) ** -0.5),
        'cmp_w2': nrm(ks[7], (DEPTH, 2, CMP_HIDDEN, B_DH), CMP_HIDDEN ** -0.5),
        'w_mem_kv': nrm(ks[8], (DEPTH, D_MODEL, 2 * M_HEADS * M_DH), D_MODEL ** -0.5),
        'w_branch': nrm(ks[9], (DEPTH, N_BRANCH, MIX_W, D_MODEL), MIX_W ** -0.5),
        'w_out': nrm(ks[10], (DEPTH, D_MODEL, D_MODEL), BETA * D_MODEL ** -0.5),
        'ln1_g': 1.0 + nrm(ks[11], (DEPTH, D_MODEL), 0.02),
        'ln1_b': nrm(ks[12], (DEPTH, D_MODEL), 0.02),
        'peer_wq': nrm(ks[13], (DEPTH, D_MODEL, PEER_HEADS * PEER_DKEY), D_MODEL ** -0.5),
        'peer_keys': nrm(ks[14], (DEPTH, PEER_HEADS, 2, PEER_NKEYS, PEER_DKEY // 2), (PEER_DKEY // 2) ** -0.5),
        'peer_u': nrm(ks[15], (DEPTH, PEER_EXPERTS, D_MODEL), D_MODEL ** -0.5),
        'peer_v': nrm(ks[16], (DEPTH, PEER_EXPERTS, D_MODEL), BETA),
        'ln2_g': 1.0 + nrm(ks[17], (DEPTH, D_MODEL), 0.02),
        'ln2_b': nrm(ks[18], (DEPTH, D_MODEL), 0.02),
        'rel_bias': nrm(ks[19], (REL_BUCKETS, A_HEADS + B_HEADS), 0.3),
    }


def reference(x, mem, w_in, diff_lambda, diff_subln, cmp_pe, cmp_w1, cmp_w2, w_mem_kv, w_branch, w_out, ln1_g, ln1_b, peer_wq, peer_keys, peer_u, peer_v, ln2_g, ln2_b, rel_bias):
    split_at = np.cumsum(IN_WIDTHS)[:-1].tolist()
    for l in range(DEPTH):
        B, T, _ = x.shape
        h = x @ w_in[l]
        a_q, a_k, a_v, b_q, b_kv, b_g, m_q, merge = jnp.split(h, split_at, axis=-1)
        o_a = diff_attention(a_q.reshape(B, T, A_HEADS, 2, A_DQK), a_k.reshape(B, T, A_HEADS, 2, A_DQK), a_v.reshape(B, T, A_HEADS, A_DV), diff_lambda[l], diff_subln[l], rel_bias[:, :A_HEADS], lambda_init(l))
        o_b = nsa_attention(b_q.reshape(B, T, B_HEADS, B_DH), b_kv.reshape(B, T, N_NSA_BRANCH, 2, B_GROUPS, B_DH), b_g.reshape(B, T, N_NSA_BRANCH, B_HEADS), cmp_pe[l], cmp_w1[l], cmp_w2[l], rel_bias[:, A_HEADS:])
        o_m = memory_attention(m_q, mem, w_mem_kv[l])
        branches = jnp.stack([o_a, o_b, o_m], axis=2)
        up = jnp.einsum('btnc,ncd->btnd', branches, w_branch[l])
        gates = jax.nn.sigmoid(merge.astype(jnp.float32)).astype(x.dtype).reshape(B, T, N_BRANCH, D_MODEL)
        y = jnp.sum(gates * up, axis=2) @ w_out[l]
        x = layer_norm(ALPHA * x + y, ln1_g[l], ln1_b[l])
        x = layer_norm(ALPHA * x + peer_ffn(x, peer_wq[l], peer_keys[l], peer_u[l], peer_v[l]), ln2_g[l], ln2_b[l])
    return x
```

```cpp
#include <hip/hip_runtime.h>
#include <stdint.h>
#include <math.h>

typedef unsigned short bf16_t;
__device__ __forceinline__ float bf2f(bf16_t v) { return __uint_as_float(((unsigned)v) << 16); }
__device__ __forceinline__ bf16_t f2bf(float f) { unsigned u = __float_as_uint(f); u += 0x7FFFu + ((u >> 16) & 1u); return (bf16_t)(u >> 16); }

constexpr int NB = 2, T = 4096, D = 2048, NTOK = NB * T;
constexpr int CIN = 12848, HP = 12800;
constexpr int OFF_AQ = 0, OFF_AK = 1024, OFF_AV = 2048, OFF_BQ = 3072, OFF_BKV = 4096, OFF_MQ = 5632, OFF_MG = 6656;
constexpr int NCMP = 255;
constexpr float ALPHA = 1.189207115002721f;

__device__ __forceinline__ float gelu_tanh(float x) { const float u = 0.7978845608028654f * (x + 0.044715f * x * x * x); return 0.5f * x * (1.0f + tanhf(u)); }
__device__ __forceinline__ float sigmoidf_(float x) { return 1.0f / (1.0f + expf(-x)); }
__device__ __forceinline__ int rel_bucket(int n) {
    if (n < 16) return n;
    const float v = logf((float)n / 16.0f) / 4.1588830833596715f * 16.0f;
    int large = 16 + (int)v; return large > 31 ? 31 : large;
}

template <class LA, class LB, class ST>
__global__ __launch_bounds__(256) void k_gemm(int M, int N, int K, LA la, LB lb, ST st) {
    __shared__ float As[16][65];
    __shared__ float Bs[16][65];
    const int tx = threadIdx.x & 15, ty = threadIdx.x >> 4; const int m0 = blockIdx.y * 64, n0 = blockIdx.x * 64;
    float acc[4][4];
#pragma unroll
    for (int i = 0; i < 4; ++i)
#pragma unroll
        for (int j = 0; j < 4; ++j) acc[i][j] = 0.f;
    for (int k0 = 0; k0 < K; k0 += 16) {
        for (int i = threadIdx.x; i < 1024; i += 256) { const int kk = i & 15, mm = i >> 4; const int m = m0 + mm; As[kk][mm] = (m < M) ? la(m, k0 + kk) : 0.f; }
        for (int i = threadIdx.x; i < 1024; i += 256) { const int nn = i & 63, kk = i >> 6; const int n = n0 + nn; Bs[kk][nn] = (n < N) ? lb(k0 + kk, n) : 0.f; }
        __syncthreads();
#pragma unroll
        for (int kk = 0; kk < 16; ++kk) {
            float a[4], b[4];
#pragma unroll
            for (int i = 0; i < 4; ++i) { a[i] = As[kk][ty * 4 + i]; b[i] = Bs[kk][tx * 4 + i]; }
#pragma unroll
            for (int i = 0; i < 4; ++i)
#pragma unroll
                for (int j = 0; j < 4; ++j) acc[i][j] += a[i] * b[j];
        }
        __syncthreads();
    }
#pragma unroll
    for (int i = 0; i < 4; ++i)
#pragma unroll
        for (int j = 0; j < 4; ++j) { const int m = m0 + ty * 4 + i, n = n0 + tx * 4 + j; if (m < M && n < N) st(m, n, acc[i][j]); }
}

__device__ __forceinline__ float blk_max(float v, float* red) {
    for (int o = 32; o; o >>= 1) v = fmaxf(v, __shfl_xor(v, o));
    __syncthreads(); if ((threadIdx.x & 63) == 0) red[threadIdx.x >> 6] = v; __syncthreads();
    return fmaxf(fmaxf(red[0], red[1]), fmaxf(red[2], red[3]));
}
__device__ __forceinline__ float blk_sum(float v, float* red) {
    for (int o = 32; o; o >>= 1) v += __shfl_xor(v, o);
    __syncthreads(); if ((threadIdx.x & 63) == 0) red[threadIdx.x >> 6] = v; __syncthreads();
    return (red[0] + red[1]) + (red[2] + red[3]);
}
__device__ __forceinline__ float blk_softmax(float* s, int n, float* red) {
    float m = -INFINITY; for (int i = threadIdx.x; i < n; i += 256) m = fmaxf(m, s[i]);
    m = blk_max(m, red); if (m == -INFINITY) m = 0.f;
    float l = 0.f; for (int i = threadIdx.x; i < n; i += 256) { const float x = s[i]; const float e = (x == -INFINITY) ? 0.f : expf(x - m); s[i] = e; l += e; }
    l = blk_sum(l, red); return l;
}
template <int DQK> __device__ __forceinline__ float kdot(const bf16_t* k, const float* q) {
    float acc = 0.f;
#pragma unroll
    for (int i = 0; i < DQK; i += 8) { const uint4 w = *(const uint4*)(k + i); const unsigned u[4] = {w.x, w.y, w.z, w.w};
#pragma unroll
        for (int j = 0; j < 4; ++j) { acc += __uint_as_float(u[j] << 16) * q[i + 2 * j]; acc += __uint_as_float(u[j] & 0xffff0000u) * q[i + 2 * j + 1]; } }
    return acc;
}
template <int DV, class VR> __device__ __forceinline__ float blk_pv(const float* s, int n, VR vrow, float* red2) {
    constexpr int NP = 256 / DV; const int d = threadIdx.x % DV, part = threadIdx.x / DV; float acc = 0.f;
    for (int i = part; i < n; i += NP) { const float p = s[i]; if (p != 0.f) acc += p * bf2f(vrow(i)[d]); }
    __syncthreads(); red2[threadIdx.x] = acc; __syncthreads();
    if (part == 0) for (int pp = 1; pp < NP; ++pp) acc += red2[pp * DV + d];
    return acc;
}

__global__ __launch_bounds__(256) void k_diff(const bf16_t* __restrict__ Hb, const float* __restrict__ relb, const float* __restrict__ lamp, const float* __restrict__ subg, bf16_t* __restrict__ OA) {
    __shared__ float s[T]; __shared__ float q[64]; __shared__ float red[4]; __shared__ float red2[256];
    const int t = blockIdx.x, h = blockIdx.y, b = blockIdx.z; const size_t row = (size_t)b * T + t;
    float om[2];
    for (int m = 0; m < 2; ++m) {
        __syncthreads();
        if (threadIdx.x < 64) q[threadIdx.x] = bf2f(Hb[row * HP + OFF_AQ + h * 128 + m * 64 + threadIdx.x]);
        __syncthreads();
        for (int k = threadIdx.x; k <= t; k += 256) {
            const bf16_t* kp = Hb + ((size_t)b * T + k) * HP + OFF_AK + h * 128 + m * 64;
            s[k] = kdot<64>(kp, q) * 0.125f + relb[rel_bucket(t - k) * 24 + h];
        }
        __syncthreads();
        const float l = blk_softmax(s, t + 1, red);
        const float o = blk_pv<128>(s, t + 1, [&](int i) { return Hb + ((size_t)b * T + i) * HP + OFF_AV + h * 128; }, red2);
        om[m] = o / fmaxf(l, 1e-30f);
    }
    const float lam = lamp[0];
    float o = (threadIdx.x < 128) ? (om[0] - lam * om[1]) : 0.f;
    const float ss = blk_sum(o * o, red);
    const float r = rsqrtf(ss * (1.0f / 128.0f) + 1e-5f);
    if (threadIdx.x < 128) OA[row * 1024 + h * 128 + threadIdx.x] = f2bf(o * r * subg[threadIdx.x] * 0.8f);
}

template <int NPL> __device__ __forceinline__ void wave_top16(float (&v)[NPL], const int (&id)[NPL], const int (&pay)[NPL], float& outv, int& outi, int& outp) {
    const int lane = threadIdx.x & 63; outv = 0.f; outi = 0; outp = 0;
    for (int it = 0; it < 16; ++it) {
        float bv = v[0]; int bi = id[0], bp = pay[0];
#pragma unroll
        for (int j = 1; j < NPL; ++j) if (v[j] > bv || (v[j] == bv && id[j] < bi)) { bv = v[j]; bi = id[j]; bp = pay[j]; }
        for (int off = 32; off; off >>= 1) {
            const float ov = __shfl_xor(bv, off); const int oi = __shfl_xor(bi, off), op = __shfl_xor(bp, off);
            if (ov > bv || (ov == bv && oi < bi)) { bv = ov; bi = oi; bp = op; }
        }
        if (lane == it) { outv = bv; outi = bi; outp = bp; }
#pragma unroll
        for (int j = 0; j < NPL; ++j) if (id[j] == bi) v[j] = -INFINITY;
    }
}

__global__ __launch_bounds__(256) void k_cmp(const bf16_t* __restrict__ Hb, const bf16_t* __restrict__ KC, const bf16_t* __restrict__ VC, const float* __restrict__ GS,
                                             float* __restrict__ OBC, unsigned long long* __restrict__ SELM) {
    __shared__ float s[256]; __shared__ float psum[260]; __shared__ float q[64]; __shared__ float red[4]; __shared__ float red2[256];
    const int t = blockIdx.x, g = blockIdx.y, b = blockIdx.z; const size_t row = (size_t)b * T + t;
    psum[threadIdx.x] = 0.f; if (threadIdx.x < 4) psum[256 + threadIdx.x] = 0.f;
    const bf16_t* kc = KC + (size_t)(b * 4 + g) * 256 * 64; const bf16_t* vc = VC + (size_t)(b * 4 + g) * 256 * 64;
    for (int hg = 0; hg < 4; ++hg) {
        const int hb = g * 4 + hg;
        __syncthreads();
        if (threadIdx.x < 64) q[threadIdx.x] = bf2f(Hb[row * HP + OFF_BQ + hb * 64 + threadIdx.x]);
        __syncthreads();
        { const int c = threadIdx.x; float sc = -INFINITY; if (c < NCMP && 16 * c + 31 <= t) sc = kdot<64>(kc + c * 64, q) * 0.125f; s[c] = sc; }
        __syncthreads();
        const float l = blk_softmax(s, 256, red);
        const float inv = 1.0f / fmaxf(l, 1e-30f);
        psum[threadIdx.x] += s[threadIdx.x] * inv;
        const float o = blk_pv<64>(s, NCMP, [&](int i) { return vc + i * 64; }, red2);
        if (threadIdx.x < 64) OBC[row * 1024 + hb * 64 + threadIdx.x] = GS[row * 48 + 0 * 16 + hb] * (o * inv);
    }
    __syncthreads();
    if (threadIdx.x < 64) {
        const int j = threadIdx.x; const int cur = t >> 6;
        float imp = psum[4 * j] + psum[4 * j + 1] + psum[4 * j + 2] + 0.5f * psum[4 * j + 3] + (j > 0 ? 0.5f * psum[4 * j - 1] : 0.f);
        const bool forced = (j == 0) || (j == cur) || (j == cur - 1); const bool future = j * 64 > t;
        imp = forced ? 1e9f : (future ? -1e9f : imp);
        float v[1] = {imp}; int id[1] = {j}; int pay[1] = {0}; float ov; int oi, op;
        wave_top16<1>(v, id, pay, ov, oi, op);
        unsigned long long bit = (j < 16 && oi * 64 <= t) ? (1ull << oi) : 0ull;
        for (int off = 32; off; off >>= 1) bit |= __shfl_xor(bit, off);
        if (j == 0) SELM[(size_t)(b * 4 + g) * T + t] = bit;
    }
}

__global__ __launch_bounds__(256) void k_win(const bf16_t* __restrict__ Hb, const float* __restrict__ relb, const float* __restrict__ GS, float* __restrict__ OBW) {
    __shared__ float s[512]; __shared__ float q[64]; __shared__ float red[4]; __shared__ float red2[256];
    const int t = blockIdx.x, g = blockIdx.y, b = blockIdx.z; const size_t row = (size_t)b * T + t;
    for (int hg = 0; hg < 4; ++hg) {
        const int hb = g * 4 + hg;
        __syncthreads();
        if (threadIdx.x < 64) q[threadIdx.x] = bf2f(Hb[row * HP + OFF_BQ + hb * 64 + threadIdx.x]);
        __syncthreads();
        for (int i = threadIdx.x; i < 512; i += 256) { const int kpos = t - i; float sc = -INFINITY;
            if (kpos >= 0) sc = kdot<64>(Hb + ((size_t)b * T + kpos) * HP + OFF_BKV + 2 * 512 + 0 * 256 + g * 64, q) * 0.125f + relb[rel_bucket(i) * 24 + 8 + hb];
            s[i] = sc; }
        __syncthreads();
        const float l = blk_softmax(s, 512, red);
        const float o = blk_pv<64>(s, 512, [&](int i) { return Hb + ((size_t)b * T + (t - i)) * HP + OFF_BKV + 2 * 512 + 256 + g * 64; }, red2);
        if (threadIdx.x < 64) OBW[row * 1024 + hb * 64 + threadIdx.x] = GS[row * 48 + 2 * 16 + hb] * (o / fmaxf(l, 1e-30f));
    }
}

__global__ __launch_bounds__(256) void k_sel(const bf16_t* __restrict__ Hb, const float* __restrict__ relb, const float* __restrict__ GS, const unsigned long long* __restrict__ SELM,
                                             const float* __restrict__ OBC, const float* __restrict__ OBW, bf16_t* __restrict__ OB) {
    __shared__ float s[1024]; __shared__ int blist[16]; __shared__ int nsel_s; __shared__ float q[64]; __shared__ float red[4]; __shared__ float red2[256];
    const int t = blockIdx.x, g = blockIdx.y, b = blockIdx.z; const size_t row = (size_t)b * T + t;
    if (threadIdx.x == 0) { unsigned long long m = SELM[(size_t)(b * 4 + g) * T + t]; int n = 0; for (int j = 0; j < 64; ++j) if ((m >> j) & 1ull) { if (n < 16) blist[n] = j; ++n; } nsel_s = n < 16 ? n : 16; }
    __syncthreads();
    const int nk = nsel_s * 64;
    for (int hg = 0; hg < 4; ++hg) {
        const int hb = g * 4 + hg;
        __syncthreads();
        if (threadIdx.x < 64) q[threadIdx.x] = bf2f(Hb[row * HP + OFF_BQ + hb * 64 + threadIdx.x]);
        __syncthreads();
        for (int i = threadIdx.x; i < nk; i += 256) { const int kpos = blist[i >> 6] * 64 + (i & 63); float sc = -INFINITY;
            if (kpos <= t) sc = kdot<64>(Hb + ((size_t)b * T + kpos) * HP + OFF_BKV + 1 * 512 + 0 * 256 + g * 64, q) * 0.125f + relb[rel_bucket(t - kpos) * 24 + 8 + hb];
            s[i] = sc; }
        __syncthreads();
        const float l = blk_softmax(s, nk, red);
        const float o = blk_pv<64>(s, nk, [&](int i) { return Hb + ((size_t)b * T + blist[i >> 6] * 64 + (i & 63)) * HP + OFF_BKV + 1 * 512 + 256 + g * 64; }, red2);
        if (threadIdx.x < 64) { const size_t oi = row * 1024 + hb * 64 + threadIdx.x; OB[oi] = f2bf(OBC[oi] + OBW[oi] + GS[row * 48 + 1 * 16 + hb] * (o / fmaxf(l, 1e-30f))); }
    }
}

__global__ __launch_bounds__(256) void k_mem(const bf16_t* __restrict__ Hb, const bf16_t* __restrict__ KVM, bf16_t* __restrict__ OM) {
    __shared__ float s[256]; __shared__ float q[256]; __shared__ float red[4]; __shared__ float red2[256];
    const int t = blockIdx.x, hm = blockIdx.y, b = blockIdx.z; const size_t row = (size_t)b * T + t;
    q[threadIdx.x] = bf2f(Hb[row * HP + OFF_MQ + hm * 256 + threadIdx.x]);
    __syncthreads();
    s[threadIdx.x] = kdot<256>(KVM + ((size_t)b * 256 + threadIdx.x) * 2048 + hm * 256, q) * 0.0625f;
    __syncthreads();
    const float l = blk_softmax(s, 256, red);
    const float o = blk_pv<256>(s, 256, [&](int i) { return KVM + ((size_t)b * 256 + i) * 2048 + 1024 + hm * 256; }, red2);
    OM[row * 1024 + hm * 256 + threadIdx.x] = f2bf(o / fmaxf(l, 1e-30f));
}

__global__ __launch_bounds__(256) void k_ln(const float* __restrict__ Z, const float* __restrict__ g, const float* __restrict__ bb, float* __restrict__ out, bf16_t* __restrict__ outb) {
    __shared__ float red[4];
    const size_t row = blockIdx.x; float v[8]; float s = 0.f;
#pragma unroll
    for (int i = 0; i < 8; ++i) { v[i] = Z[row * D + threadIdx.x + 256 * i]; s += v[i]; }
    const float mu = blk_sum(s, red) * (1.0f / D); float q = 0.f;
#pragma unroll
    for (int i = 0; i < 8; ++i) { const float d = v[i] - mu; q += d * d; }
    const float r = rsqrtf(blk_sum(q, red) * (1.0f / D) + 1e-5f);
#pragma unroll
    for (int i = 0; i < 8; ++i) { const int c = threadIdx.x + 256 * i; const float o = (v[i] - mu) * r * g[c] + bb[c]; out[row * D + c] = o; if (outb) outb[row * D + c] = f2bf(o); }
}

__global__ __launch_bounds__(256) void k_scores(const float* __restrict__ PQ, const float* __restrict__ keys, float* __restrict__ SC) {
    __shared__ float q[2048];
    const size_t n = blockIdx.x;
    for (int i = threadIdx.x; i < 2048; i += 256) q[i] = PQ[n * 2048 + i];
    __syncthreads();
    for (int o = threadIdx.x; o < 2048; o += 256) { const int hc = o >> 7, k = o & 127; const float* kp = keys + ((size_t)hc * 128 + k) * 128; float acc = 0.f;
        for (int d = 0; d < 128; ++d) acc += q[hc * 128 + d] * kp[d];
        SC[n * 2048 + o] = acc; }
}
__global__ __launch_bounds__(256) void k_route(const float* __restrict__ SC, int* __restrict__ EIDX, float* __restrict__ EGATE) {
    const int lane = threadIdx.x & 63; const size_t w = (size_t)blockIdx.x * 4 + (threadIdx.x >> 6); const size_t n = w >> 3; const int h = (int)(w & 7);
    float s0, s1; int i0, i1, dum;
    { float v[2] = {SC[n * 2048 + h * 256 + lane], SC[n * 2048 + h * 256 + 64 + lane]}; int id[2] = {lane, lane + 64}; int pay[2] = {0, 0}; wave_top16<2>(v, id, pay, s0, i0, dum); }
    { float v[2] = {SC[n * 2048 + h * 256 + 128 + lane], SC[n * 2048 + h * 256 + 192 + lane]}; int id[2] = {lane, lane + 64}; int pay[2] = {0, 0}; wave_top16<2>(v, id, pay, s1, i1, dum); }
    float v[4]; int id[4], pay[4];
#pragma unroll
    for (int j = 0; j < 4; ++j) { const int c = lane * 4 + j; const int a = c >> 4, bq = c & 15; v[j] = __shfl(s0, a) + __shfl(s1, bq); id[j] = c; pay[j] = __shfl(i0, a) * 128 + __shfl(i1, bq); }
    float sf; int pos, ex; wave_top16<4>(v, id, pay, sf, pos, ex);
    const float mx = __shfl(sf, 0); float e = (lane < 16) ? expf(sf - mx) : 0.f; float sum = e;
    for (int off = 32; off; off >>= 1) sum += __shfl_xor(sum, off);
    if (lane < 16) { EIDX[n * 128 + h * 16 + lane] = ex; EGATE[n * 128 + h * 16 + lane] = e / sum; }
}
__global__ __launch_bounds__(256) void k_expert(const float* __restrict__ X1, const int* __restrict__ EIDX, const float* __restrict__ EGATE, const float* __restrict__ U, const float* __restrict__ V, float* __restrict__ Z2) {
    __shared__ float xs[2048]; __shared__ float cf[128]; __shared__ int ei[128];
    const size_t n = blockIdx.x; const int lane = threadIdx.x & 63, wid = threadIdx.x >> 6;
    for (int i = threadIdx.x; i < 2048; i += 256) xs[i] = X1[n * 2048 + i];
    if (threadIdx.x < 128) ei[threadIdx.x] = EIDX[n * 128 + threadIdx.x];
    __syncthreads();
    for (int k = wid; k < 128; k += 4) { const float* up = U + (size_t)ei[k] * 2048; float acc = 0.f;
        for (int d = lane; d < 2048; d += 64) acc += xs[d] * up[d];
        for (int off = 32; off; off >>= 1) acc += __shfl_xor(acc, off);
        if (lane == 0) cf[k] = EGATE[n * 128 + k] * gelu_tanh(acc); }
    __syncthreads();
    float o[8];
#pragma unroll
    for (int i = 0; i < 8; ++i) o[i] = 0.f;
    for (int k = 0; k < 128; ++k) { const float c = cf[k]; const float* vp = V + (size_t)ei[k] * 2048;
#pragma unroll
        for (int i = 0; i < 8; ++i) o[i] += c * vp[threadIdx.x + 256 * i]; }
#pragma unroll
    for (int i = 0; i < 8; ++i) { const int c = threadIdx.x + 256 * i; Z2[n * 2048 + c] = ALPHA * xs[c] + o[i]; }
}

__global__ void k_misc(const float* __restrict__ dl, float* __restrict__ lamp, bf16_t* __restrict__ KC, bf16_t* __restrict__ VC) {
    if (blockIdx.x == 0 && threadIdx.x == 0) { float a = 0.f, b = 0.f; for (int i = 0; i < 64; ++i) { a += dl[i] * dl[64 + i]; b += dl[128 + i] * dl[192 + i]; } lamp[0] = expf(a) - expf(b) + 0.2f; }
    const int i = blockIdx.x * blockDim.x + threadIdx.x; if (i < 8 * 64) { const int bg = i >> 6, d = i & 63; KC[((size_t)bg * 256 + 255) * 64 + d] = 0; VC[((size_t)bg * 256 + 255) * 64 + d] = 0; }
}

struct LA_f32 { const float* A; int lda; int pad; __device__ float operator()(int m, int k) const { return A[(size_t)m * lda + k]; } };
struct LA_bf16 { const bf16_t* A; int lda; int pad; __device__ float operator()(int m, int k) const { return bf2f(A[(size_t)m * lda + k]); } };
struct LB_f32 { const float* Bm; int ldb; int pad; __device__ float operator()(int k, int n) const { return Bm[(size_t)k * ldb + n]; } };
struct LB_win { const float* W; __device__ float operator()(int k, int n) const { return W[(size_t)k * CIN + (n < 5632 ? n : n + 48)]; } };
struct LB_wing { const float* W; __device__ float operator()(int k, int n) const { return W[(size_t)k * CIN + 5632 + n]; } };
struct ST_h { bf16_t* Hb; __device__ void operator()(int m, int n, float v) const { Hb[(size_t)m * HP + n] = f2bf(n >= OFF_MG ? sigmoidf_(v) : v); } };
struct ST_gs { float* GS; __device__ void operator()(int m, int n, float v) const { GS[(size_t)m * 48 + n] = sigmoidf_(v); } };
struct ST_bf16 { bf16_t* C; int ldc; int pad; __device__ void operator()(int m, int n, float v) const { C[(size_t)m * ldc + n] = f2bf(v); } };
struct ST_f32 { float* C; int ldc; int pad; __device__ void operator()(int m, int n, float v) const { C[(size_t)m * ldc + n] = v; } };
struct LA_cmp { const bf16_t* Hb; const float* pe; int kv; int pad; __device__ float operator()(int m, int k) const { const int bg = m / NCMP, c = m % NCMP, b = bg >> 2, g = bg & 3, l = k >> 6, d = k & 63;
        return bf2f(Hb[((size_t)b * T + 16 * c + l) * HP + OFF_BKV + kv * 256 + g * 64 + d]) + pe[(kv * 32 + l) * 64 + d]; } };
struct ST_gelu { float* C; int ldc; int pad; __device__ void operator()(int m, int n, float v) const { C[(size_t)m * ldc + n] = gelu_tanh(v); } };
struct ST_kc { bf16_t* C; __device__ void operator()(int m, int n, float v) const { const int bg = m / NCMP, c = m % NCMP; C[((size_t)bg * 256 + c) * 64 + n] = f2bf(v); } };
struct ST_br { float* YSf; bf16_t* YS; const bf16_t* Hb; int nb; int pad; __device__ void operator()(int m, int n, float v) const { const float gte = bf2f(Hb[(size_t)m * HP + OFF_MG + nb * 2048 + n]);
        float r = gte * v; if (nb > 0) r += YSf[(size_t)m * D + n]; YSf[(size_t)m * D + n] = r; if (nb == 2) YS[(size_t)m * D + n] = f2bf(r); } };
struct ST_res { float* Z; const float* X; __device__ void operator()(int m, int n, float v) const { Z[(size_t)m * D + n] = ALPHA * X[(size_t)m * D + n] + v; } };

template <class LA, class LB, class ST> static void gemm(hipStream_t s, int M, int N, int K, LA la, LB lb, ST st) {
    k_gemm<LA, LB, ST><<<dim3((N + 63) / 64, (M + 63) / 64), 256, 0, s>>>(M, N, K, la, lb, st);
}

extern "C" void kernel_launch(void* const* d_in, const int* in_sizes, int n_in, void* d_out, int out_size, void* d_ws, size_t ws_size, hipStream_t stream) {
    const float* x = (const float*)d_in[0]; const float* mem = (const float*)d_in[1]; const float* w_in = (const float*)d_in[2]; const float* diff_lambda = (const float*)d_in[3];
    const float* diff_subln = (const float*)d_in[4]; const float* cmp_pe = (const float*)d_in[5]; const float* cmp_w1 = (const float*)d_in[6]; const float* cmp_w2 = (const float*)d_in[7];
    const float* w_mem_kv = (const float*)d_in[8]; const float* w_branch = (const float*)d_in[9]; const float* w_out = (const float*)d_in[10]; const float* ln1_g = (const float*)d_in[11];
    const float* ln1_b = (const float*)d_in[12]; const float* peer_wq = (const float*)d_in[13]; const float* peer_keys = (const float*)d_in[14]; const float* peer_u = (const float*)d_in[15];
    const float* peer_v = (const float*)d_in[16]; const float* ln2_g = (const float*)d_in[17]; const float* ln2_b = (const float*)d_in[18]; const float* rel_bias = (const float*)d_in[19];
    float* out = (float*)d_out;
    char* ws = (char*)d_ws; size_t off = 0;
    auto take = [&](size_t bytes) { char* p = ws + off; off += (bytes + 255) & ~(size_t)255; return p; };
    char* R_H = take((size_t)NTOK * HP * 2);
    char* R_P = take((size_t)NTOK * 1024 * 4 * 2);
    char* R_Y = take((size_t)NTOK * D * 4);
    bf16_t* YS = (bf16_t*)take((size_t)NTOK * D * 2);
    bf16_t* OA = (bf16_t*)take((size_t)NTOK * 1024 * 2); bf16_t* OB = (bf16_t*)take((size_t)NTOK * 1024 * 2); bf16_t* OM = (bf16_t*)take((size_t)NTOK * 1024 * 2);
    float* GS = (float*)take((size_t)NTOK * 48 * 4);
    bf16_t* KVM = (bf16_t*)take((size_t)512 * 2048 * 2);
    float* HID = (float*)take((size_t)2 * 2040 * 256 * 4);
    bf16_t* KC = (bf16_t*)take((size_t)8 * 256 * 64 * 2); bf16_t* VC = (bf16_t*)take((size_t)8 * 256 * 64 * 2);
    unsigned long long* SELM = (unsigned long long*)take((size_t)8 * T * 8);
    int* EIDX = (int*)take((size_t)NTOK * 128 * 4); float* EGATE = (float*)take((size_t)NTOK * 128 * 4);
    float* lamp = (float*)take(256);
    bf16_t* Hb = (bf16_t*)R_H; float* OBC = (float*)R_P; float* OBW = OBC + (size_t)NTOK * 1024; float* YSf = (float*)R_Y;
    float* Z = (float*)R_H; float* X1 = Z + (size_t)NTOK * D; bf16_t* X1b = (bf16_t*)(X1 + (size_t)NTOK * D); float* PQ = (float*)R_P; float* SC = (float*)R_Y; float* Z2 = Z;

    k_misc<<<2, 256, 0, stream>>>(diff_lambda, lamp, KC, VC);
    gemm(stream, NTOK, HP, D, LA_f32{x, D}, LB_win{w_in}, ST_h{Hb});
    gemm(stream, NTOK, 48, D, LA_f32{x, D}, LB_wing{w_in}, ST_gs{GS});
    gemm(stream, 512, 2048, D, LA_f32{mem, D}, LB_f32{w_mem_kv, 2048}, ST_bf16{KVM, 2048});
    for (int kv = 0; kv < 2; ++kv) {
        gemm(stream, 8 * NCMP, 256, 2048, LA_cmp{Hb, cmp_pe, kv}, LB_f32{cmp_w1 + (size_t)kv * 2048 * 256, 256}, ST_gelu{HID + (size_t)kv * 2040 * 256, 256});
        gemm(stream, 8 * NCMP, 64, 256, LA_f32{HID + (size_t)kv * 2040 * 256, 256}, LB_f32{cmp_w2 + (size_t)kv * 256 * 64, 64}, ST_kc{kv ? VC : KC});
    }
    k_diff<<<dim3(T, 8, NB), 256, 0, stream>>>(Hb, rel_bias, lamp, diff_subln, OA);
    k_cmp<<<dim3(T, 4, NB), 256, 0, stream>>>(Hb, KC, VC, GS, OBC, SELM);
    k_win<<<dim3(T, 4, NB), 256, 0, stream>>>(Hb, rel_bias, GS, OBW);
    k_sel<<<dim3(T, 4, NB), 256, 0, stream>>>(Hb, rel_bias, GS, SELM, OBC, OBW, OB);
    k_mem<<<dim3(T, 4, NB), 256, 0, stream>>>(Hb, KVM, OM);
    const bf16_t* br[3] = {OA, OB, OM};
    for (int nb = 0; nb < 3; ++nb) gemm(stream, NTOK, D, 1024, LA_bf16{br[nb], 1024}, LB_f32{w_branch + (size_t)nb * 1024 * 2048, 2048}, ST_br{YSf, YS, Hb, nb});
    gemm(stream, NTOK, D, D, LA_bf16{YS, D}, LB_f32{w_out, D}, ST_res{Z, x});
    k_ln<<<NTOK, 256, 0, stream>>>(Z, ln1_g, ln1_b, X1, X1b);
    gemm(stream, NTOK, D, D, LA_f32{X1, D}, LB_f32{peer_wq, D}, ST_f32{PQ, D});
    k_scores<<<NTOK, 256, 0, stream>>>(PQ, peer_keys, SC);
    k_route<<<NTOK * 8 / 4, 256, 0, stream>>>(SC, EIDX, EGATE);
    k_expert<<<NTOK, 256, 0, stream>>>(X1, EIDX, EGATE, peer_u, peer_v, Z2);
    k_ln<<<NTOK, 256, 0, stream>>>(Z2, ln2_g, ln2_b, out, (bf16_t*)nullptr);
}
```
